# Optimizing an MI355X kernel written in HIP

```python
import jax, jax.numpy as jnp
from jax import lax
import numpy as np

D_MODEL = 1024
BATCH = 8
SEQ = 4096
DEPTH = 1

HEAD_DIM = 64
SB_HEADS = 8
SW_HEADS = 8
SW_KV_HEADS = 2
SB_WIDTH = SB_HEADS * HEAD_DIM
SW_WIDTH = SW_HEADS * HEAD_DIM
SW_KV_WIDTH = SW_KV_HEADS * HEAD_DIM
MIX_WIDTH = SB_WIDTH + SW_WIDTH
WINDOW = 128
BLOCK = 128
RMS_EPS = 1e-6
NEG_INF = -1e30
IN_SPLIT_SIZES = (SB_WIDTH, SB_WIDTH, SB_WIDTH, SB_WIDTH, SW_WIDTH, SW_KV_WIDTH, SW_KV_WIDTH, SW_WIDTH)
IN_WIDTH = 4 * SB_WIDTH + 2 * SW_WIDTH + 2 * SW_KV_WIDTH

kernel_name = "hymba_stickbreak_swa_sink_adaln"


def rmsnorm(x, g):
    xf = x.astype(jnp.float32)
    y = xf * lax.rsqrt(jnp.mean(xf * xf, axis=-1, keepdims=True) + RMS_EPS)
    return (y * g.astype(jnp.float32)).astype(x.dtype)


def alibi_slopes(n):
    return jnp.asarray([2.0 ** (-8.0 * (h + 1) / n) for h in range(n)], dtype=jnp.float32)


def stick_breaking_attention(q, k, v):
    S, Dh = q.shape[1], q.shape[3]
    scale = Dh ** -0.5
    outs = []
    for start in range(0, S, BLOCK):
        end = start + BLOCK
        qb = q[:, start:end]
        kb = k[:, :end]
        vb = v[:, :end]
        z = jnp.einsum('bqhd,bkhd->bhqk', qb, kb).astype(jnp.float32) * scale
        qpos = start + jnp.arange(BLOCK)[:, None]
        kpos = jnp.arange(end)[None, :]
        causal = kpos < qpos
        log_beta = jax.nn.log_sigmoid(z)
        log_1mb = jnp.where(causal, jax.nn.log_sigmoid(-z), 0.0)
        later = lax.cumsum(log_1mb, axis=3, reverse=True) - log_1mb
        w = jnp.where(causal, jnp.exp(log_beta + later), 0.0)
        outs.append(jnp.einsum('bhqk,bkhd->bqhd', w.astype(v.dtype), vb))
    return jnp.concatenate(outs, axis=1)


def sliding_window_sink_attention(q, k, v, sinks, slopes):
    B, S, H, Dh = q.shape
    Hkv = k.shape[2]
    G = H // Hkv
    nb = S // BLOCK
    qb = q.reshape(B, nb, BLOCK, Hkv, G, Dh)

    def band(t):
        tb = t.reshape(B, nb, BLOCK, Hkv, Dh)
        prev = jnp.pad(tb[:, :-1], ((0, 0), (1, 0), (0, 0), (0, 0), (0, 0)))
        return jnp.concatenate([prev, tb], axis=2)

    kb, vb = band(k), band(v)
    s = jnp.einsum('bnqhgd,bnshd->bhgnqs', qb, kb).astype(jnp.float32) * (Dh ** -0.5)
    r = jnp.arange(BLOCK)[:, None]
    j = jnp.arange(2 * BLOCK)[None, :]
    rel = (BLOCK + r - j)
    kpos = (jnp.arange(nb)[:, None, None] - 1) * BLOCK + j[None]
    valid = (rel >= 0)[None] & (rel < WINDOW)[None] & (kpos >= 0)
    m = slopes.reshape(Hkv, G)[:, :, None, None, None]
    logits = s - m * rel.astype(jnp.float32)
    logits = jnp.where(valid, logits, NEG_INF)
    sink = jnp.broadcast_to(sinks.astype(jnp.float32).reshape(1, Hkv, G, 1, 1, 1),
                            logits.shape[:-1] + (1,))
    p = jax.nn.softmax(jnp.concatenate([logits, sink], axis=-1), axis=-1)[..., :-1]
    o = jnp.einsum('bhgnqs,bnshd->bnqhgd', p.astype(v.dtype), vb)
    return o.reshape(B, S, H, Dh)


def setup_inputs(seed: int = 0) -> dict:
    key = jax.random.key(seed)
    ks = jax.random.split(key, 11)
    D = D_MODEL
    x = jax.random.normal(ks[0], (BATCH, SEQ, D), jnp.float32)
    c = jax.random.normal(ks[1], (BATCH, D), jnp.float32)
    w_ada = jax.random.normal(ks[2], (DEPTH, D, 3 * D), jnp.float32) * (0.5 * D ** -0.5)
    b_ada = jax.random.normal(ks[3], (DEPTH, 3 * D), jnp.float32) * 0.01
    norm_g = 1.0 + 0.01 * jax.random.normal(ks[4], (DEPTH, D), jnp.float32)
    w_in = jax.random.normal(ks[5], (DEPTH, D, IN_WIDTH), jnp.float32) * (D ** -0.5)
    sinks = jax.random.normal(ks[6], (DEPTH, SW_HEADS), jnp.float32) * 0.5
    w_out = jax.random.normal(ks[7], (DEPTH, MIX_WIDTH, D), jnp.float32) * (MIX_WIDTH ** -0.5)
    final_g = 1.0 + 0.01 * jax.random.normal(ks[8], (D,), jnp.float32)
    return {"x": x, "c": c, "w_ada": w_ada, "b_ada": b_ada, "norm_g": norm_g,
            "w_in": w_in, "sinks": sinks, "w_out": w_out, "final_g": final_g}


def reference(x, c, w_ada, b_ada, norm_g, w_in, sinks, w_out, final_g):
    B, S, _ = x.shape
    slopes = alibi_slopes(SW_HEADS)
    offsets = np.cumsum(IN_SPLIT_SIZES)[:-1].tolist()
    cond = jax.nn.silu(c)
    for l in range(DEPTH):
        mod = cond @ w_ada[l] + b_ada[l]
        shift, scale, gate = jnp.split(mod, 3, axis=-1)
        h = rmsnorm(x, norm_g[l]) * (1.0 + scale[:, None, :]) + shift[:, None, :]
        proj = h @ w_in[l]
        sb_q, sb_k, sb_v, sb_g, sw_q, sw_k, sw_v, sw_g = jnp.split(proj, offsets, axis=-1)
        y_sb = stick_breaking_attention(
            sb_q.reshape(B, S, SB_HEADS, HEAD_DIM),
            sb_k.reshape(B, S, SB_HEADS, HEAD_DIM),
            sb_v.reshape(B, S, SB_HEADS, HEAD_DIM)).reshape(B, S, SB_WIDTH)
        y_sb = y_sb * jax.nn.silu(sb_g)
        y_sw = sliding_window_sink_attention(
            sw_q.reshape(B, S, SW_HEADS, HEAD_DIM),
            sw_k.reshape(B, S, SW_KV_HEADS, HEAD_DIM),
            sw_v.reshape(B, S, SW_KV_HEADS, HEAD_DIM),
            sinks[l], slopes).reshape(B, S, SW_WIDTH)
        y_sw = y_sw * jax.nn.silu(sw_g)
        y = jnp.concatenate([y_sb, y_sw], axis=-1) @ w_out[l]
        x = x + gate[:, None, :] * y
    return rmsnorm(x, final_g)
```

```cpp
#include <hip/hip_runtime.h>
#include <hip/hip_cooperative_groups.h>
#include <cstdio>
#include <cstdint>
namespace cg = cooperative_groups;
#ifndef MK_N_LAUNCHES
#define MK_N_LAUNCHES 1
#endif
constexpr int BATCH = 8, SEQ = 4096, DM = 1024, MTOK = BATCH * SEQ, NIN = 3328, NADA = 3072;
constexpr float RMS_EPS = 1e-6f;
constexpr float LOG2E = 1.4426950408889634f;
constexpr float C2 = 0.125f * LOG2E;
namespace pg8 {
#define PG8_LAS __attribute__((address_space(3)))
typedef unsigned short bf16_t;
typedef short bf16x8 __attribute__((ext_vector_type(8)));
typedef float f32x4 __attribute__((ext_vector_type(4)));
typedef unsigned u32x4 __attribute__((ext_vector_type(4)));
constexpr int BM = 256, BK = 64, HALF = 128, HTB = HALF * BK * 2  , STAGE_BYTES = 8 * HTB, NXCD = 8, WGM = 8;

__host__ __device__ __forceinline__ int lds_byte(int r, int c) { const int st = (r >> 4) * 2 + (c >> 5), rr = r & 15, cc = c & 31, ob = rr * 64 + cc * 2; return st * 1024 + (ob ^ (((ob >> 9) & 1) << 5)); }
__host__ __device__ __forceinline__ void stage_rc(int b, int& R, int& C) { const int st = b / 1024, sb = b % 1024, swz = sb ^ (((sb >> 9) & 1) << 5); R = (st >> 1) * 16 + swz / 64; C = (st & 1) * 32 + (swz % 64) / 2; }
__host__ __device__ __forceinline__ int perm32(int rho) { const int n = rho >> 4, i = rho & 15; return 8 * (i >> 2) + 4 * n + (i & 3); }

struct Unit { int pm, pn; };
struct Gemm { const bf16_t* A; const bf16_t* Bt; int M, N, K; };

struct StaticOrder {
    int nM, nN, nwg, G, c;
    __host__ __device__ void init(int M, int N, int G_, int c_) { nM = M / BM; nN = N / BM; nwg = nM * nN; G = G_; c = c_; }
    __host__ __device__ bool next(int i, Unit& u) const {
        const long L = (long)i * G + c; if (L >= nwg) return false;
        int wgid = (int)L; { const int q = nwg / NXCD, r = nwg % NXCD, xcd = wgid % NXCD, off = wgid / NXCD; wgid = (xcd < r ? xcd * (q + 1) : r * (q + 1) + (xcd - r) * q) + off; }
        const int nig = WGM * nN, gid = wgid / nig, fm = gid * WGM, gsz = (nM - fm) < WGM ? (nM - fm) : WGM;
        u.pm = fm + ((wgid % nig) % gsz); u.pn = (wgid % nig) / gsz; return true;
    }
    __device__ __forceinline__ void a_ready(const Unit&) const {}
    __device__ __forceinline__ void done(const Unit&) const {}
};

__device__ __forceinline__ unsigned cvt_pk_bf16(float lo, float hi) { unsigned r; asm volatile("v_cvt_pk_bf16_f32 %0, %1, %2" : "=v"(r) : "v"(lo), "v"(hi)); return r; }
typedef float f32x2 __attribute__((ext_vector_type(2)));
struct EpiProj {
    static constexpr bool PERM = true, AFTER_DRAIN = false;
    bf16_t* O;
    __device__ __forceinline__ void operator()(const f32x4 (&acc)[2][2][4][2], const Unit& u, int wr, int wc, int fr, int fq) const {
        const int row0 = u.pm * BM + wr * 64 + fr;
        const int col0 = u.pn * BM + wc * 32 + 8 * fq;
#pragma unroll
        for (int bj = 0; bj < 2; ++bj) {
            const int cb = u.pn * 2 + bj;
            const int mode = (cb < 4 || (cb >= 16 && cb < 20)) ? 1 : (((cb >= 12 && cb < 16) || cb >= 22) ? 2 : 0);
#pragma unroll
            for (int ai = 0; ai < 2; ++ai)
#pragma unroll
                for (int m = 0; m < 4; ++m) {
                    bf16_t* rowp = O + (size_t)(row0 + ai * HALF + m * 16) * NIN + col0 + bj * HALF;
                    f32x4 v0 = acc[ai][bj][m][0], v1 = acc[ai][bj][m][1];
                    if (mode == 1) { v0 = v0 * C2; v1 = v1 * C2; }
                    else if (mode == 2) {
#pragma unroll
                        for (int j = 0; j < 4; ++j) {
                            v0[j] = v0[j] * __builtin_amdgcn_rcpf(1.0f + __builtin_amdgcn_exp2f(-LOG2E * v0[j]));
                            v1[j] = v1[j] * __builtin_amdgcn_rcpf(1.0f + __builtin_amdgcn_exp2f(-LOG2E * v1[j]));
                        }
                    }
                    u32x4 w; w.x = cvt_pk_bf16(v0[0], v0[1]); w.y = cvt_pk_bf16(v0[2], v0[3]); w.z = cvt_pk_bf16(v1[0], v1[1]); w.w = cvt_pk_bf16(v1[2], v1[3]);
                    *(u32x4*)rowp = w;
                }
        }
    }
};
struct EpiOut {
    static constexpr bool PERM = true, AFTER_DRAIN = false;
    const float* x; const float* gate; float* out; float* ssq;
    __device__ __forceinline__ void operator()(const f32x4 (&acc)[2][2][4][2], const Unit& u, int wr, int wc, int fr, int fq) const {
        const int col0 = u.pn * BM + wc * 32 + 8 * fq;
        const int b = (u.pm * BM) / SEQ;
        f32x4 gv[2][2];
#pragma unroll
        for (int bj = 0; bj < 2; ++bj)
#pragma unroll
            for (int n = 0; n < 2; ++n) gv[bj][n] = *(const f32x4*)(gate + b * DM + col0 + bj * HALF + 4 * n);
#pragma unroll
        for (int ai = 0; ai < 2; ++ai)
#pragma unroll
            for (int m = 0; m < 4; ++m) {
                const int row = u.pm * BM + ai * HALF + wr * 64 + m * 16 + fr;
                const size_t off = (size_t)row * DM + col0;
                float s = 0.f;
#pragma unroll
                for (int bj = 0; bj < 2; ++bj)
#pragma unroll
                    for (int n = 0; n < 2; ++n) {
                        const f32x4 xv = *(const f32x4*)(x + off + bj * HALF + 4 * n);
                        const f32x4 o = xv + gv[bj][n] * acc[ai][bj][m][n];
                        *(f32x4*)(out + off + bj * HALF + 4 * n) = o;
                        s += (o[0] * o[0] + o[1] * o[1]) + (o[2] * o[2] + o[3] * o[3]);
                    }
                s += __shfl_xor(s, 16); s += __shfl_xor(s, 32);
                if (fq == 0) atomicAdd(ssq + row, s);
            }
    }
};
template <class Epi, class Sched, bool ALIGN_EPI = false, bool SP2 = false>
__device__ __forceinline__ void gemm_phase(PG8_LAS unsigned char* lds, const Gemm g, const Sched& S, const Epi& E) {
    const int tid = threadIdx.x, wid = __builtin_amdgcn_readfirstlane(tid >> 6), lane = tid & 63, wr = wid >> 2, wc = wid & 3, fr = lane & 15, fq = lane >> 4;
    const int K = g.K, nt = K / BK;
    unsigned voffA[2], voffB[2];
#pragma unroll
    for (int i = 0; i < 2; ++i) { int R, C; stage_rc(tid * 16 + i * 8192, R, C); const int Rb = Epi::PERM ? ((R & ~31) + perm32(R & 31)) : R;
        voffA[i] = (unsigned)(R * K + C) * 2u; voffB[i] = (unsigned)(Rb * K + C) * 2u; }
    const size_t kstep = (size_t)(BK * 2);
    const size_t hstep = (size_t)HALF * K * 2;
    const size_t tstep = 2 * hstep;
    const unsigned ldsw = (unsigned)wid * 1024u;
    const int aoff = lds_byte(wr * 64 + fr, fq * 8), boff = lds_byte(wc * 32 + fr, fq * 8);
#define PG8_SA(b, h) (((b) * 2 + (h)) * HTB)
#define PG8_SB(b, h) ((4 + (b) * 2 + (h)) * HTB)
#define PG8_STAGE(bufoff, gbase, voff) do { _Pragma("unroll") for (int _i = 0; _i < 2; ++_i) \
        __builtin_amdgcn_global_load_lds((const unsigned*)((const char*)(gbase) + (voff)[_i]), (PG8_LAS unsigned*)(lds + (bufoff) + ldsw + _i * 8192), 16, 0, 0); } while (0)
#define PG8_LDA(dst, b, h) do { _Pragma("unroll") for (int m = 0; m < 4; ++m) _Pragma("unroll") for (int k = 0; k < 2; ++k) dst[m][k] = *(const PG8_LAS bf16x8*)(lds + PG8_SA(b, h) + aoff + m * 2048 + k * 1024); } while (0)
#define PG8_LDB(dst, b, h) do { _Pragma("unroll") for (int n = 0; n < 2; ++n) _Pragma("unroll") for (int k = 0; k < 2; ++k) dst[n][k] = *(const PG8_LAS bf16x8*)(lds + PG8_SB(b, h) + boff + n * 2048 + k * 1024); } while (0)
#define PG8_MMA(ai, bj, At, Bt) do { __builtin_amdgcn_s_setprio(1); _Pragma("unroll") for (int m = 0; m < 4; ++m) _Pragma("unroll") for (int n = 0; n < 2; ++n) _Pragma("unroll") for (int k = 0; k < 2; ++k) \
        acc[ai][bj][m][n] = __builtin_amdgcn_mfma_f32_16x16x32_bf16(Bt[n][k], At[m][k], acc[ai][bj][m][n], 0, 0, 0); __builtin_amdgcn_s_setprio(0); } while (0)
#define PG8_WAIT_V(n) asm volatile("s_waitcnt vmcnt(" #n ")" ::: "memory")
#define PG8_WAIT_L(n) asm volatile("s_waitcnt lgkmcnt(" #n ")" ::: "memory")
#define PG8_BAR __builtin_amdgcn_s_barrier()
#define PG8_SCHED __builtin_amdgcn_sched_barrier(0)
    Unit cur, nxt; int ui = 0;
    if (!S.next(0, cur)) return;
    f32x4 acc[2][2][4][2];
#pragma unroll
    for (int a = 0; a < 2; ++a)
#pragma unroll
        for (int b = 0; b < 2; ++b)
#pragma unroll
            for (int m = 0; m < 4; ++m)
#pragma unroll
                for (int n = 0; n < 2; ++n) acc[a][b][m][n] = (f32x4){0.f, 0.f, 0.f, 0.f};
    bf16x8 At[4][2], B0[2][2], B1[2][2];
    const char* cA = (const char*)g.A + (size_t)cur.pm * tstep; const char* cB = (const char*)g.Bt + (size_t)cur.pn * tstep;
    S.a_ready(cur);
    if constexpr (SP2) {
        PG8_STAGE(PG8_SB(0, 0), cB, voffB); PG8_STAGE(PG8_SB(0, 1), cB + hstep, voffB); PG8_STAGE(PG8_SA(0, 0), cA, voffA); PG8_STAGE(PG8_SA(0, 1), cA + hstep, voffA);
        if (wr == 1) PG8_BAR;
        PG8_WAIT_V(2); PG8_BAR;
        PG8_STAGE(PG8_SB(1, 0), cB + kstep, voffB); PG8_STAGE(PG8_SA(1, 0), cA + kstep, voffA); PG8_STAGE(PG8_SB(1, 1), cB + hstep + kstep, voffB);
        PG8_WAIT_V(6); PG8_BAR;
    } else {
        PG8_STAGE(PG8_SB(0, 0), cB, voffB); PG8_STAGE(PG8_SA(0, 0), cA, voffA); PG8_STAGE(PG8_SB(0, 1), cB + hstep, voffB); PG8_STAGE(PG8_SA(0, 1), cA + hstep, voffA);
        if (wr == 1) PG8_BAR;
        PG8_WAIT_V(4); PG8_BAR;
        PG8_STAGE(PG8_SB(1, 0), cB + kstep, voffB); PG8_STAGE(PG8_SA(1, 0), cA + kstep, voffA); PG8_STAGE(PG8_SB(1, 1), cB + hstep + kstep, voffB);
        PG8_WAIT_V(6); PG8_BAR;
    }
    for (;;) {
        const bool has_next = S.next(ui + 1, nxt);
        const char* nA = has_next ? (const char*)g.A + (size_t)nxt.pm * tstep : cA; const char* nB = has_next ? (const char*)g.Bt + (size_t)nxt.pn * tstep : cB;
        for (int t = 0; t < nt; t += 2) {
            const bool last = (t == nt - 2);
            const char* a1 = cA + (size_t)(t + 1) * kstep;
            const char* a2 = last ? nA : cA + (size_t)(t + 2) * kstep; const char* b2 = last ? nB : cB + (size_t)(t + 2) * kstep;
            const char* a3 = a2 + kstep; const char* b3 = b2 + kstep;
            if (last && has_next) S.a_ready(nxt);
            if constexpr (SP2) {
            PG8_LDB(B0, 0, 0); PG8_LDB(B1, 0, 1); PG8_SCHED; PG8_LDA(At, 0, 0); PG8_STAGE(PG8_SA(1, 1), a1 + hstep, voffA);
            PG8_WAIT_V(8); PG8_WAIT_L(0); PG8_BAR; PG8_MMA(0, 0, At, B0); PG8_MMA(0, 1, At, B1); PG8_BAR; PG8_SCHED;
            PG8_LDA(At, 0, 1); PG8_STAGE(PG8_SB(0, 0), b2, voffB); PG8_STAGE(PG8_SB(0, 1), b2 + hstep, voffB); PG8_STAGE(PG8_SA(0, 0), a2, voffA);
            PG8_WAIT_V(8); PG8_WAIT_L(0); PG8_BAR; PG8_MMA(1, 0, At, B0); PG8_MMA(1, 1, At, B1); PG8_BAR; PG8_SCHED;
            PG8_LDB(B0, 1, 0); PG8_LDB(B1, 1, 1); PG8_SCHED; PG8_LDA(At, 1, 0); PG8_STAGE(PG8_SA(0, 1), a2 + hstep, voffA);
            PG8_WAIT_V(8); PG8_WAIT_L(0); PG8_BAR; PG8_MMA(0, 0, At, B0); PG8_MMA(0, 1, At, B1); PG8_BAR; PG8_SCHED;
            PG8_LDA(At, 1, 1); PG8_STAGE(PG8_SB(1, 0), b3, voffB); PG8_STAGE(PG8_SB(1, 1), b3 + hstep, voffB); PG8_STAGE(PG8_SA(1, 0), a3, voffA);
            PG8_WAIT_V(8); PG8_WAIT_L(0); PG8_BAR; PG8_MMA(1, 0, At, B0); PG8_MMA(1, 1, At, B1); PG8_BAR; PG8_SCHED;
            } else {
            PG8_LDB(B0, 0, 0); PG8_SCHED; PG8_LDA(At, 0, 0); PG8_STAGE(PG8_SA(1, 1), a1 + hstep, voffA);
            PG8_WAIT_L(8); PG8_BAR; PG8_WAIT_L(0); PG8_MMA(0, 0, At, B0); PG8_BAR; PG8_SCHED;
            PG8_LDB(B1, 0, 1); PG8_STAGE(PG8_SB(0, 0), b2, voffB);
            PG8_BAR; PG8_WAIT_L(0); PG8_MMA(0, 1, At, B1); PG8_BAR;
            PG8_LDA(At, 0, 1); PG8_STAGE(PG8_SA(0, 0), a2, voffA);
            PG8_BAR; PG8_WAIT_L(0); PG8_MMA(1, 0, At, B0); PG8_BAR; PG8_SCHED;
            PG8_STAGE(PG8_SB(0, 1), b2 + hstep, voffB);
            PG8_WAIT_V(6); PG8_BAR; PG8_MMA(1, 1, At, B1); PG8_BAR;
            PG8_LDB(B0, 1, 0); PG8_SCHED; PG8_LDA(At, 1, 0); PG8_STAGE(PG8_SA(0, 1), a2 + hstep, voffA);
            PG8_WAIT_L(8); PG8_BAR; PG8_WAIT_L(0); PG8_MMA(0, 0, At, B0); PG8_BAR; PG8_SCHED;
            PG8_LDB(B1, 1, 1); PG8_STAGE(PG8_SB(1, 0), b3, voffB);
            PG8_BAR; PG8_WAIT_L(0); PG8_MMA(0, 1, At, B1); PG8_BAR;
            PG8_LDA(At, 1, 1); PG8_STAGE(PG8_SA(1, 0), a3, voffA);
            PG8_BAR; PG8_WAIT_L(0); PG8_MMA(1, 0, At, B0); PG8_BAR; PG8_SCHED;
            PG8_STAGE(PG8_SB(1, 1), b3 + hstep, voffB);
            PG8_WAIT_V(6); PG8_BAR; PG8_MMA(1, 1, At, B1); PG8_BAR;
            }
        }
        if constexpr (ALIGN_EPI) { if (wr == 0) PG8_BAR; }
        if constexpr (!Epi::AFTER_DRAIN) { E(acc, cur, wr, wc, fr, fq); S.done(cur); }
        if (!has_next) break;
#pragma unroll
        for (int a = 0; a < 2; ++a)
#pragma unroll
            for (int b = 0; b < 2; ++b)
#pragma unroll
                for (int m = 0; m < 4; ++m)
#pragma unroll
                    for (int n = 0; n < 2; ++n) acc[a][b][m][n] = (f32x4){0.f, 0.f, 0.f, 0.f};
        cur = nxt; cA = nA; cB = nB; ++ui;
        if constexpr (ALIGN_EPI) { if (wr == 1) PG8_BAR; }
    }
    PG8_WAIT_V(0);
    if constexpr (!ALIGN_EPI) { if (wr == 0) PG8_BAR; }
    PG8_BAR;
    if constexpr (Epi::AFTER_DRAIN) { E.fused(acc, cur, wr, wc, fr, fq, lds, wid, lane); S.done(cur); }
#undef PG8_SA
#undef PG8_SB
#undef PG8_STAGE
#undef PG8_LDA
#undef PG8_LDB
#undef PG8_MMA
#undef PG8_WAIT_V
#undef PG8_WAIT_L
#undef PG8_BAR
#undef PG8_SCHED
}
}
#define LAS __attribute__((address_space(3)))
#define DI __device__ __forceinline__
typedef unsigned short bf16_t;
typedef short bf16x8 __attribute__((ext_vector_type(8)));
typedef short s16x4 __attribute__((ext_vector_type(4)));
typedef float f32x16 __attribute__((ext_vector_type(16)));
typedef float f32x4 __attribute__((ext_vector_type(4)));
typedef unsigned u32x4 __attribute__((ext_vector_type(4)));
typedef unsigned u32x2 __attribute__((ext_vector_type(2)));
typedef float f32x2_t __attribute__((ext_vector_type(2)));
typedef __bf16 bf16x2_t __attribute__((ext_vector_type(2)));
DI unsigned cvtpk(float lo, float hi) { f32x2_t v = {lo, hi}; bf16x2_t b = __builtin_convertvector(v, bf16x2_t); return __builtin_bit_cast(unsigned, b); }
DI float bf_lo(unsigned u) { return __uint_as_float(u << 16); }
DI float bf_hi(unsigned u) { return __uint_as_float(u & 0xffff0000u); }
DI int crow(int i, int hh) { return (i & 3) + 8 * (i >> 2) + 4 * hh; }
DI float swap_max(float m) { auto rr = __builtin_amdgcn_permlane32_swap(__float_as_uint(m), __float_as_uint(m), false, false); return fmaxf(__uint_as_float(rr[0]), __uint_as_float(rr[1])); }
DI float swap_sum(float m) { auto rr = __builtin_amdgcn_permlane32_swap(__float_as_uint(m), __float_as_uint(m), false, false); return __uint_as_float(rr[0]) + __uint_as_float(rr[1]); }
DI s16x4 vtr(LAS const unsigned char* p) { return __builtin_bit_cast(s16x4, __builtin_amdgcn_ds_read_tr16_b64_v4i16((LAS s16x4*)p)); }
#define MFMA32(a, b, c) __builtin_amdgcn_mfma_f32_32x32x16_bf16((a), (b), (c), 0, 0, 0)
constexpr int KP = 144, TILE_B = 64 * KP, BUF_B = 2 * TILE_B;
constexpr int ATT_LDS = 2 * BUF_B;

template <int MODE>
DI void attn_unit(LAS unsigned char* lds, const bf16_t* __restrict__ P, bf16_t* __restrict__ Y, const float* __restrict__ sinks, int b, int h, int qb) {
    const int tid = threadIdx.x, lane = tid & 63, r = lane & 31, hh = lane >> 5;
    const int wid = __builtin_amdgcn_readfirstlane(tid >> 6);
    const size_t rowbase = (size_t)b * SEQ;
    const int q0w = qb * 256 + wid * 32;
    const int qcol = MODE == 0 ? h * 64 : 2048 + h * 64;
    const int kcol = MODE == 0 ? 512 + h * 64 : 2560 + (h >> 2) * 64;
    const int vcol = MODE == 0 ? 1024 + h * 64 : 2688 + (h >> 2) * 64;
    const int gcol = MODE == 0 ? 1536 + h * 64 : 2816 + h * 64;
    const int ycol = MODE == 0 ? h * 64 : 512 + h * 64;
    bf16x8 qf[4];
    { const bf16_t* qp = P + (rowbase + q0w + r) * NIN + qcol + 8 * hh;
#pragma unroll
      for (int s = 0; s < 4; ++s) qf[s] = *(const bf16x8*)(qp + 16 * s); }
    bf16x8 tm[2], ones;
#pragma unroll
    for (int s = 0; s < 2; ++s)
#pragma unroll
        for (int j = 0; j < 8; ++j) tm[s][j] = ((16 * s + 8 * (j >> 2) + 4 * hh + (j & 3)) > r) ? (short)0x3F80 : (short)0;
#pragma unroll
    for (int j = 0; j < 8; ++j) ones[j] = (short)0x3F80;
    const int t_hi = 4 * qb + 3;
    const int t_lo = MODE == 0 ? 0 : (4 * qb - 2 > 0 ? 4 * qb - 2 : 0);
    const int skey = tid >> 3, sch = tid & 7;
    const bf16_t* kg = P + (rowbase + skey) * NIN + kcol + sch * 8;
    const bf16_t* vg = P + (rowbase + skey) * NIN + vcol + sch * 8;
    const int soff = skey * KP + sch * 16;
    u32x4 kreg = *(const u32x4*)(kg + (size_t)t_hi * 64 * NIN), vreg = *(const u32x4*)(vg + (size_t)t_hi * 64 * NIN);
    f32x16 o0, o1, carry;
#pragma unroll
    for (int i = 0; i < 16; ++i) { o0[i] = 0.f; o1[i] = 0.f; carry[i] = 0.f; }
    float mrun = 0.f, lsum = 0.f, slope2 = 0.f;
    if (MODE == 1) { mrun = sinks[h] * LOG2E; lsum = hh == 0 ? 1.f : 0.f; slope2 = __builtin_amdgcn_exp2f(-(float)(h + 1)) * LOG2E; }
    const int vtoff = (4 * hh + ((lane & 15) >> 2)) * KP + ((lane >> 4) & 1) * 32 + (lane & 3) * 8;
    int buf = 0;
    for (int t = t_hi; t >= t_lo; --t) {
        LAS unsigned char* kb = lds + buf * BUF_B; LAS unsigned char* vb = kb + TILE_B;
        *(LAS u32x4*)(kb + soff) = kreg; *(LAS u32x4*)(vb + soff) = vreg;
        __syncthreads();
        if (t > t_lo) { kreg = *(const u32x4*)(kg + (size_t)(t - 1) * 64 * NIN); vreg = *(const u32x4*)(vg + (size_t)(t - 1) * 64 * NIN); }
#pragma unroll
        for (int c = 1; c >= 0; --c) {
            const int ks = 64 * t + 32 * c;
            const bool active = MODE == 0 ? (ks <= q0w) : (ks <= q0w && ks >= q0w - 128);
            if (active) {
                f32x16 z;
#pragma unroll
                for (int i = 0; i < 16; ++i) z[i] = 0.f;
#pragma unroll
                for (int s = 0; s < 4; ++s) { const bf16x8 kf = *(LAS const bf16x8*)(kb + (32 * c + r) * KP + (16 * s + 8 * hh) * 2); z = MFMA32(kf, qf[s], z); }
                u32x4 wk0, wk1;
                if (MODE == 0) {
                    const bool diag = (ks == q0w);
                    f32x16 sp;
#pragma unroll
                    for (int i = 0; i < 16; ++i) {
                        const float zz = z[i];
                        const float uu = __builtin_amdgcn_exp2f(-fabsf(zz));
                        float s_ = fmaxf(zz, 0.f) + __builtin_amdgcn_logf(1.0f + uu);
                        if (diag && !(crow(i, hh) < r)) s_ = 0.f;
                        sp[i] = s_;
                    }
                    u32x4 sk0, sk1;
                    sk0.x = cvtpk(sp[0], sp[1]); sk0.y = cvtpk(sp[2], sp[3]); sk0.z = cvtpk(sp[4], sp[5]); sk0.w = cvtpk(sp[6], sp[7]);
                    sk1.x = cvtpk(sp[8], sp[9]); sk1.y = cvtpk(sp[10], sp[11]); sk1.z = cvtpk(sp[12], sp[13]); sk1.w = cvtpk(sp[14], sp[15]);
                    const bf16x8 s0 = __builtin_bit_cast(bf16x8, sk0), s1 = __builtin_bit_cast(bf16x8, sk1);
                    f32x16 yc = MFMA32(tm[0], s0, carry); yc = MFMA32(tm[1], s1, yc);
                    carry = MFMA32(ones, s0, carry); carry = MFMA32(ones, s1, carry);
                    f32x16 w;
#pragma unroll
                    for (int i = 0; i < 16; ++i) {
                        float e = __builtin_amdgcn_exp2f(z[i] - sp[i] - yc[i]);
                        if (diag && !(crow(i, hh) < r)) e = 0.f;
                        w[i] = e;
                    }
                    wk0.x = cvtpk(w[0], w[1]); wk0.y = cvtpk(w[2], w[3]); wk0.z = cvtpk(w[4], w[5]); wk0.w = cvtpk(w[6], w[7]);
                    wk1.x = cvtpk(w[8], w[9]); wk1.y = cvtpk(w[10], w[11]); wk1.z = cvtpk(w[12], w[13]); wk1.w = cvtpk(w[14], w[15]);
                } else {
                    const float relb = (float)(q0w - ks + r - 4 * hh);
                    float mx = -1e30f;
#pragma unroll
                    for (int i = 0; i < 16; ++i) {
                        const float rel = relb - (float)((i & 3) + 8 * (i >> 2));
                        const bool valid = rel >= 0.f && rel < 128.f;
                        const float l = valid ? z[i] - slope2 * rel : -1e30f;
                        z[i] = l; mx = fmaxf(mx, l);
                    }
                    mx = swap_max(mx);
                    const float mnew = fmaxf(mrun, mx);
                    const float alpha = __builtin_amdgcn_exp2f(mrun - mnew);
                    mrun = mnew; lsum *= alpha;
#pragma unroll
                    for (int i = 0; i < 16; ++i) { o0[i] *= alpha; o1[i] *= alpha; }
                    float ps = 0.f;
#pragma unroll
                    for (int i = 0; i < 16; ++i) { z[i] = __builtin_amdgcn_exp2f(z[i] - mnew); ps += z[i]; }
                    lsum += ps;
                    wk0.x = cvtpk(z[0], z[1]); wk0.y = cvtpk(z[2], z[3]); wk0.z = cvtpk(z[4], z[5]); wk0.w = cvtpk(z[6], z[7]);
                    wk1.x = cvtpk(z[8], z[9]); wk1.y = cvtpk(z[10], z[11]); wk1.z = cvtpk(z[12], z[13]); wk1.w = cvtpk(z[14], z[15]);
                }
                const bf16x8 w0 = __builtin_bit_cast(bf16x8, wk0), w1 = __builtin_bit_cast(bf16x8, wk1);
                LAS const unsigned char* vp = vb + (32 * c) * KP + vtoff;
#pragma unroll
                for (int s = 0; s < 2; ++s) {
                    const s16x4 a0 = vtr(vp + (16 * s) * KP), a1 = vtr(vp + (16 * s + 8) * KP);
                    const s16x4 b0 = vtr(vp + (16 * s) * KP + 64), b1 = vtr(vp + (16 * s + 8) * KP + 64);
                    const bf16x8 va = (bf16x8){a0[0], a0[1], a0[2], a0[3], a1[0], a1[1], a1[2], a1[3]};
                    const bf16x8 vbq = (bf16x8){b0[0], b0[1], b0[2], b0[3], b1[0], b1[1], b1[2], b1[3]};
                    o0 = MFMA32(va, s == 0 ? w0 : w1, o0);
                    o1 = MFMA32(vbq, s == 0 ? w0 : w1, o1);
                }
            }
        }
        buf ^= 1;
    }
    if (MODE == 1) { const float inv = 1.0f / swap_sum(lsum);
#pragma unroll
        for (int i = 0; i < 16; ++i) { o0[i] *= inv; o1[i] *= inv; } }
    { bf16_t* yrow = Y + (rowbase + q0w + r) * DM + ycol; const bf16_t* grow = P + (rowbase + q0w + r) * NIN + gcol;
#pragma unroll
      for (int db = 0; db < 2; ++db)
#pragma unroll
        for (int g4 = 0; g4 < 4; ++g4) {
            const int d0 = 32 * db + 8 * g4 + 4 * hh;
            const u32x2 gg = *(const u32x2*)(grow + d0);
            const float v0 = (db == 0 ? o0 : o1)[4 * g4 + 0] * bf_lo(gg.x), v1 = (db == 0 ? o0 : o1)[4 * g4 + 1] * bf_hi(gg.x);
            const float v2 = (db == 0 ? o0 : o1)[4 * g4 + 2] * bf_lo(gg.y), v3 = (db == 0 ? o0 : o1)[4 * g4 + 3] * bf_hi(gg.y);
            u32x2 ov; ov.x = cvtpk(v0, v1); ov.y = cvtpk(v2, v3);
            *(u32x2*)(yrow + d0) = ov;
        } }
    __syncthreads();
}

constexpr size_t MiB = 1u << 20;
constexpr size_t WS_PART = 1 * MiB;
constexpr size_t WS_GATE = 1 * MiB + 512 * 1024;
constexpr size_t WS_SSQ  = 1 * MiB + 768 * 1024;
constexpr size_t WS_WIN  = 2 * MiB;
constexpr size_t WS_WOUT = 10 * MiB;
constexpr size_t WS_H    = 16 * MiB;
constexpr size_t WS_P    = 80 * MiB;
constexpr size_t WS_END  = WS_P + (size_t)MTOK * NIN * 2;
constexpr int LDS_BYTES = 147456;
constexpr int NWAVES = 8;

DI float wave_sum(float v) {
#pragma unroll
    for (int o = 1; o < 64; o <<= 1) v += __shfl_xor(v, o);
    return v;
}
DI unsigned f2bf(float f) { unsigned u = __builtin_bit_cast(unsigned, f); return (u + 0x7fffu + ((u >> 16) & 1u)) >> 16; }
DI unsigned pk2(float lo, float hi) { return f2bf(lo) | (f2bf(hi) << 16); }
DI void transpose_item(const float* __restrict__ W, int K, int N, bf16_t* __restrict__ WT, LAS float* scr, int item, int lane) {
    const int nblk = N / 32, kb = item / nblk, nb = item % nblk, k0 = 64 * kb, n0 = 32 * nb;
#pragma unroll 8
    for (int i = 0; i < 32; ++i) { const int kk = 2 * i + (lane >> 5); scr[kk * 33 + (lane & 31)] = W[(size_t)(k0 + kk) * N + n0 + (lane & 31)]; }
    asm volatile("s_waitcnt lgkmcnt(0)" ::: "memory");
    const int c = lane & 7;
#pragma unroll
    for (int j = 0; j < 4; ++j) { const int n = (lane >> 3) + 8 * j; const LAS float* s = scr + (8 * c) * 33 + n;
        u32x4 o; o.x = pk2(s[0 * 33], s[1 * 33]); o.y = pk2(s[2 * 33], s[3 * 33]); o.z = pk2(s[4 * 33], s[5 * 33]); o.w = pk2(s[6 * 33], s[7 * 33]);
        *(u32x4*)(WT + (size_t)(n0 + n) * K + k0 + 8 * c) = o; }
    asm volatile("s_waitcnt lgkmcnt(0)" ::: "memory");
}

struct Args { const float* in[9]; float* out; unsigned char* ws; int ph_lo, ph_hi; };
constexpr int N_PHASES = 6;

__global__ void __launch_bounds__(NWAVES * 64, 2) hymba_fwd(Args args) {
    extern __shared__ __attribute__((aligned(16))) unsigned char lds_raw[];
    LAS unsigned char* lds = (LAS unsigned char*)lds_raw;
    const int tid = threadIdx.x, lane = tid & 63, wave = __builtin_amdgcn_readfirstlane(tid >> 6);
    const int G = gridDim.x; const int bx = blockIdx.x;
    const int vcu = (G % 8 == 0) ? (bx % 8) * (G / 8) + bx / 8 : bx;
    const float* x = args.in[0]; const float* cvec = args.in[1]; const float* w_ada = args.in[2]; const float* b_ada = args.in[3]; const float* norm_g = args.in[4];
    const float* w_in = args.in[5]; const float* sinks = args.in[6]; const float* w_out = args.in[7]; const float* final_g = args.in[8];
    float* out = args.out; unsigned char* ws = args.ws;
    float* part = (float*)(ws + WS_PART); float* gate = (float*)(ws + WS_GATE); float* ssq = (float*)(ws + WS_SSQ);
    bf16_t* win_t = (bf16_t*)(ws + WS_WIN); bf16_t* wout_t = (bf16_t*)(ws + WS_WOUT); bf16_t* hbuf = (bf16_t*)(ws + WS_H); bf16_t* pbuf = (bf16_t*)(ws + WS_P);
    const int lo = args.ph_lo, hi = args.ph_hi;
#define IN(k) (lo <= (k) && (k) < hi)
#define SEAM(k) do { if (IN(k) && IN((k) + 1)) { cg::this_grid().sync(); } } while (0)
    const int gw = vcu * NWAVES + wave, NGW = G * NWAVES;

    if (IN(0)) {
        for (int i = bx * 512 + tid; i < MTOK; i += G * 512) ssq[i] = 0.f;
        for (int t = bx; t < 192; t += G) {
            const int cc = t % 48, kq = t / 48;
            LAS float* sc = (LAS float*)lds; LAS float* red = (LAS float*)(lds + 8192);
            for (int i = tid; i < 2048; i += 512) { const int b = i >> 8, kk = i & 255; const float cv = cvec[b * DM + kq * 256 + kk]; sc[i] = cv / (1.0f + __expf(-cv)); }
            __syncthreads();
            const int col = cc * 64 + lane, k0 = wave * 32;
            float a0 = 0.f, a1 = 0.f, a2 = 0.f, a3 = 0.f, a4 = 0.f, a5 = 0.f, a6 = 0.f, a7 = 0.f;
#pragma unroll 8
            for (int i = 0; i < 32; ++i) {
                const float w = w_ada[(size_t)(kq * 256 + k0 + i) * NADA + col];
                a0 += w * sc[0 * 256 + k0 + i]; a1 += w * sc[1 * 256 + k0 + i]; a2 += w * sc[2 * 256 + k0 + i]; a3 += w * sc[3 * 256 + k0 + i];
                a4 += w * sc[4 * 256 + k0 + i]; a5 += w * sc[5 * 256 + k0 + i]; a6 += w * sc[6 * 256 + k0 + i]; a7 += w * sc[7 * 256 + k0 + i];
            }
            red[(wave * 8 + 0) * 64 + lane] = a0; red[(wave * 8 + 1) * 64 + lane] = a1; red[(wave * 8 + 2) * 64 + lane] = a2; red[(wave * 8 + 3) * 64 + lane] = a3;
            red[(wave * 8 + 4) * 64 + lane] = a4; red[(wave * 8 + 5) * 64 + lane] = a5; red[(wave * 8 + 6) * 64 + lane] = a6; red[(wave * 8 + 7) * 64 + lane] = a7;
            __syncthreads();
            { const int b = tid >> 6; float s = 0.f;
#pragma unroll
              for (int w = 0; w < 8; ++w) s += red[(w * 8 + b) * 64 + lane];
              part[(size_t)(kq * 8 + b) * NADA + cc * 64 + lane] = s; }
            __syncthreads();
        }
        LAS float* scr = (LAS float*)(lds + wave * 16384);
        constexpr int I_IN = (DM / 64) * (NIN / 32), I_OUT = (DM / 64) * (DM / 32);
        for (int it = gw; it < I_IN + I_OUT; it += NGW) {
            if (it < I_IN) transpose_item(w_in, DM, NIN, win_t, scr, it, lane);
            else transpose_item(w_out, DM, DM, wout_t, scr, it - I_IN, lane);
        }
    }
    SEAM(0);
    if (IN(1)) {
        for (int i = bx * 512 + tid; i < BATCH * DM; i += G * 512) { const int b = i >> 10, j = 2048 + (i & 1023);
            gate[i] = b_ada[j] + ((part[(size_t)(0 * 8 + b) * NADA + j] + part[(size_t)(1 * 8 + b) * NADA + j]) + (part[(size_t)(2 * 8 + b) * NADA + j] + part[(size_t)(3 * 8 + b) * NADA + j])); }
        for (int rb = gw; rb < MTOK / 16; rb += NGW) {
            const int row0 = rb * 16, b = row0 / SEQ;
            f32x4 av[4], sh[4];
#pragma unroll
            for (int j = 0; j < 4; ++j) {
                const int col = 4 * lane + 256 * j;
                f32x4 shv = *(const f32x4*)(b_ada + col), scv = *(const f32x4*)(b_ada + 1024 + col);
#pragma unroll
                for (int kq = 0; kq < 4; ++kq) { shv += *(const f32x4*)(part + (size_t)(kq * 8 + b) * NADA + col); scv += *(const f32x4*)(part + (size_t)(kq * 8 + b) * NADA + 1024 + col); }
                const f32x4 gv = *(const f32x4*)(norm_g + col);
                av[j] = gv * (scv + 1.0f); sh[j] = shv;
            }
            for (int rr = 0; rr < 16; ++rr) {
                const float* xr = x + (size_t)(row0 + rr) * DM + 4 * lane;
                f32x4 v[4]; float s = 0.f;
#pragma unroll
                for (int j = 0; j < 4; ++j) { v[j] = *(const f32x4*)(xr + 256 * j); s += (v[j].x * v[j].x + v[j].y * v[j].y) + (v[j].z * v[j].z + v[j].w * v[j].w); }
                const float inv = 1.0f / sqrtf(wave_sum(s) * (1.0f / DM) + RMS_EPS);
                bf16_t* hr = hbuf + (size_t)(row0 + rr) * DM + 4 * lane;
#pragma unroll
                for (int j = 0; j < 4; ++j) { const f32x4 o = v[j] * inv * av[j] + sh[j]; u32x2 w; w.x = cvtpk(o.x, o.y); w.y = cvtpk(o.z, o.w); *(u32x2*)(hr + 256 * j) = w; }
            }
        }
    }
    SEAM(1);
    if (IN(2)) {
        pg8::Gemm g{hbuf, win_t, MTOK, NIN, DM}; pg8::StaticOrder S; S.init(MTOK, NIN, G, bx);
        pg8::EpiProj E{pbuf};
        pg8::gemm_phase<pg8::EpiProj, pg8::StaticOrder, true, true>(lds, g, S, E);
    }
    SEAM(2);
    if (IN(3)) {
        bf16_t* ymix = hbuf;
        for (int v = vcu; v < 256; v += G) {
            const int bh = v >> 2, s = v & 3;
#pragma unroll 1
            for (int i = 0; i < 4; ++i) { const int qb = (i == 0) ? 15 - s : (i == 1) ? 8 + s : (i == 2) ? 7 - s : s; attn_unit<0>(lds, pbuf, ymix, sinks, bh >> 3, bh & 7, qb); }
#pragma unroll 1
            for (int i = 0; i < 4; ++i) attn_unit<1>(lds, pbuf, ymix, sinks, bh >> 3, bh & 7, 4 * s + i);
        }
    }
    SEAM(3);
    if (IN(4)) {
        pg8::Gemm g{hbuf, wout_t, MTOK, DM, DM}; pg8::StaticOrder S; S.init(MTOK, DM, G, bx);
        pg8::EpiOut E{x, gate, out, ssq};
        pg8::gemm_phase<pg8::EpiOut, pg8::StaticOrder, true, true>(lds, g, S, E);
    }
    SEAM(4);
    if (IN(5)) {
        f32x4 fg[4];
#pragma unroll
        for (int j = 0; j < 4; ++j) fg[j] = *(const f32x4*)(final_g + 4 * lane + 256 * j);
        for (int row = gw; row < MTOK; row += NGW) {
            const float inv = 1.0f / sqrtf(__hip_atomic_load(ssq + row, __ATOMIC_RELAXED, __HIP_MEMORY_SCOPE_AGENT) * (1.0f / DM) + RMS_EPS);
            float* orow = out + (size_t)row * DM + 4 * lane;
#pragma unroll
            for (int j = 0; j < 4; ++j) { const f32x4 v = *(const f32x4*)(orow + 256 * j); *(f32x4*)(orow + 256 * j) = v * inv * fg[j]; }
        }
    }
#undef IN
#undef SEAM
}

extern "C" void kernel_launch(void* const* d_in, const int* in_sizes, int n_in, void* d_out, int out_size, void* d_ws, size_t ws_size, hipStream_t stream) {
    static int grid = 0;
    if (grid == 0) {
        if (n_in != 9 || out_size != MTOK * DM || ws_size < WS_END) { fprintf(stderr, "kernel_launch: unexpected shapes (n_in %d out %d ws %zu)\n", n_in, out_size, ws_size); grid = -1; return; }
        int dev = 0, cus = 0, per_cu = 0;
        hipGetDevice(&dev); hipDeviceGetAttribute(&cus, hipDeviceAttributeMultiprocessorCount, dev);
        if (hipFuncSetAttribute((const void*)hymba_fwd, hipFuncAttributeMaxDynamicSharedMemorySize, LDS_BYTES) != hipSuccess) { fprintf(stderr, "kernel_launch: hipFuncSetAttribute failed\n"); grid = -1; return; }
        if (hipOccupancyMaxActiveBlocksPerMultiprocessor(&per_cu, (const void*)hymba_fwd, NWAVES * 64, LDS_BYTES) != hipSuccess || per_cu < 1) { fprintf(stderr, "kernel_launch: occupancy query says %d\n", per_cu); per_cu = 1; }
        (void)hipGetLastError();
        grid = cus * 1;
    }
    if (grid < 0) return;
    Args a{};
    for (int i = 0; i < 9; ++i) a.in[i] = (const float*)d_in[i];
    a.out = (float*)d_out; a.ws = (unsigned char*)d_ws;
#if MK_N_LAUNCHES == 1
    a.ph_lo = 0; a.ph_hi = N_PHASES;
    void* kargs[] = {&a};
    hipError_t e = hipLaunchCooperativeKernel((const void*)hymba_fwd, dim3(grid), dim3(NWAVES * 64), kargs, LDS_BYTES, stream);
    if (e != hipSuccess) fprintf(stderr, "cooperative launch failed: %s (grid %d)\n", hipGetErrorString(e), grid);
#else
    for (int p = 0; p < N_PHASES; ++p) { a.ph_lo = p; a.ph_hi = p + 1; hipLaunchKernelGGL(hymba_fwd, dim3(grid), dim3(NWAVES * 64), LDS_BYTES, stream, a); }
#endif
}
```

```cpp
#include <hip/hip_runtime.h>
#include <hip/hip_cooperative_groups.h>
#include <cstdio>
#include <cstdint>
namespace cg = cooperative_groups;
#ifndef MK_N_LAUNCHES
#define MK_N_LAUNCHES 1
#endif
constexpr int BATCH = 8, SEQ = 4096, DM = 1024, MTOK = BATCH * SEQ, NIN = 3328, NADA = 3072;
constexpr float RMS_EPS = 1e-6f;
constexpr float LOG2E = 1.4426950408889634f;
constexpr float C2 = 0.125f * LOG2E;
namespace pg8 {
#define PG8_LAS __attribute__((address_space(3)))
typedef unsigned short bf16_t;
typedef short bf16x8 __attribute__((ext_vector_type(8)));
typedef float f32x4 __attribute__((ext_vector_type(4)));
typedef unsigned u32x4 __attribute__((ext_vector_type(4)));
constexpr int BM = 256, BK = 64, HALF = 128, HTB = HALF * BK * 2  , STAGE_BYTES = 8 * HTB, NXCD = 8, WGM = 8;

__host__ __device__ __forceinline__ int lds_byte(int r, int c) { const int st = (r >> 4) * 2 + (c >> 5), rr = r & 15, cc = c & 31, ob = rr * 64 + cc * 2; return st * 1024 + (ob ^ (((ob >> 9) & 1) << 5)); }
__host__ __device__ __forceinline__ void stage_rc(int b, int& R, int& C) { const int st = b / 1024, sb = b % 1024, swz = sb ^ (((sb >> 9) & 1) << 5); R = (st >> 1) * 16 + swz / 64; C = (st & 1) * 32 + (swz % 64) / 2; }
__host__ __device__ __forceinline__ int perm32(int rho) { const int n = rho >> 4, i = rho & 15; return 8 * (i >> 2) + 4 * n + (i & 3); }

struct Unit { int pm, pn; };
struct Gemm { const bf16_t* A; const bf16_t* Bt; int M, N, K; };

struct StaticOrder {
    int nM, nN, nwg, G, c;
    __host__ __device__ void init(int M, int N, int G_, int c_) { nM = M / BM; nN = N / BM; nwg = nM * nN; G = G_; c = c_; }
    __host__ __device__ bool next(int i, Unit& u) const {
        const long L = (long)i * G + c; if (L >= nwg) return false;
        int wgid = (int)L; { const int q = nwg / NXCD, r = nwg % NXCD, xcd = wgid % NXCD, off = wgid / NXCD; wgid = (xcd < r ? xcd * (q + 1) : r * (q + 1) + (xcd - r) * q) + off; }
        const int nig = WGM * nN, gid = wgid / nig, fm = gid * WGM, gsz = (nM - fm) < WGM ? (nM - fm) : WGM;
        u.pm = fm + ((wgid % nig) % gsz); u.pn = (wgid % nig) / gsz; return true;
    }
    __device__ __forceinline__ void a_ready(const Unit&) const {}
    __device__ __forceinline__ void done(const Unit&) const {}
};

__device__ __forceinline__ unsigned cvt_pk_bf16(float lo, float hi) { unsigned r; asm volatile("v_cvt_pk_bf16_f32 %0, %1, %2" : "=v"(r) : "v"(lo), "v"(hi)); return r; }
typedef float f32x2 __attribute__((ext_vector_type(2)));
struct EpiProj {
    static constexpr bool PERM = true, AFTER_DRAIN = false;
    bf16_t* O;
    __device__ __forceinline__ void operator()(const f32x4 (&acc)[2][2][4][2], const Unit& u, int wr, int wc, int fr, int fq) const {
        const int row0 = u.pm * BM + wr * 64 + fr;
        const int col0 = u.pn * BM + wc * 32 + 8 * fq;
#pragma unroll
        for (int bj = 0; bj < 2; ++bj) {
            const int cb = u.pn * 2 + bj;
            const int mode = (cb < 4 || (cb >= 16 && cb < 20)) ? 1 : (((cb >= 12 && cb < 16) || cb >= 22) ? 2 : 0);
#pragma unroll
            for (int ai = 0; ai < 2; ++ai)
#pragma unroll
                for (int m = 0; m < 4; ++m) {
                    bf16_t* rowp = O + (size_t)(row0 + ai * HALF + m * 16) * NIN + col0 + bj * HALF;
                    f32x4 v0 = acc[ai][bj][m][0], v1 = acc[ai][bj][m][1];
                    if (mode == 1) { v0 = v0 * C2; v1 = v1 * C2; }
                    else if (mode == 2) {
#pragma unroll
                        for (int j = 0; j < 4; ++j) {
                            v0[j] = v0[j] * __builtin_amdgcn_rcpf(1.0f + __builtin_amdgcn_exp2f(-LOG2E * v0[j]));
                            v1[j] = v1[j] * __builtin_amdgcn_rcpf(1.0f + __builtin_amdgcn_exp2f(-LOG2E * v1[j]));
                        }
                    }
                    u32x4 w; w.x = cvt_pk_bf16(v0[0], v0[1]); w.y = cvt_pk_bf16(v0[2], v0[3]); w.z = cvt_pk_bf16(v1[0], v1[1]); w.w = cvt_pk_bf16(v1[2], v1[3]);
                    *(u32x4*)rowp = w;
                }
        }
    }
};
struct EpiOut {
    static constexpr bool PERM = true, AFTER_DRAIN = false;
    const float* x; const float* gate; float* out; float* ssq;
    __device__ __forceinline__ void operator()(const f32x4 (&acc)[2][2][4][2], const Unit& u, int wr, int wc, int fr, int fq) const {
        const int col0 = u.pn * BM + wc * 32 + 8 * fq;
        const int b = (u.pm * BM) / SEQ;
        f32x4 gv[2][2];
#pragma unroll
        for (int bj = 0; bj < 2; ++bj)
#pragma unroll
            for (int n = 0; n < 2; ++n) gv[bj][n] = *(const f32x4*)(gate + b * DM + col0 + bj * HALF + 4 * n);
#pragma unroll
        for (int ai = 0; ai < 2; ++ai)
#pragma unroll
            for (int m = 0; m < 4; ++m) {
                const int row = u.pm * BM + ai * HALF + wr * 64 + m * 16 + fr;
                const size_t off = (size_t)row * DM + col0;
                float s = 0.f;
#pragma unroll
                for (int bj = 0; bj < 2; ++bj)
#pragma unroll
                    for (int n = 0; n < 2; ++n) {
                        const f32x4 xv = *(const f32x4*)(x + off + bj * HALF + 4 * n);
                        const f32x4 o = xv + gv[bj][n] * acc[ai][bj][m][n];
                        *(f32x4*)(out + off + bj * HALF + 4 * n) = o;
                        s += (o[0] * o[0] + o[1] * o[1]) + (o[2] * o[2] + o[3] * o[3]);
                    }
                s += __shfl_xor(s, 16); s += __shfl_xor(s, 32);
                if (fq == 0) atomicAdd(ssq + row, s);
            }
    }
};
template <class Epi, class Sched, bool ALIGN_EPI = false, bool SP2 = false>
__device__ __forceinline__ void gemm_phase(PG8_LAS unsigned char* lds, const Gemm g, const Sched& S, const Epi& E) {
    const int tid = threadIdx.x, wid = __builtin_amdgcn_readfirstlane(tid >> 6), lane = tid & 63, wr = wid >> 2, wc = wid & 3, fr = lane & 15, fq = lane >> 4;
    const int K = g.K, nt = K / BK;
    unsigned voffA[2], voffB[2];
#pragma unroll
    for (int i = 0; i < 2; ++i) { int R, C; stage_rc(tid * 16 + i * 8192, R, C); const int Rb = Epi::PERM ? ((R & ~31) + perm32(R & 31)) : R;
        voffA[i] = (unsigned)(R * K + C) * 2u; voffB[i] = (unsigned)(Rb * K + C) * 2u; }
    const size_t kstep = (size_t)(BK * 2);
    const size_t hstep = (size_t)HALF * K * 2;
    const size_t tstep = 2 * hstep;
    const unsigned ldsw = (unsigned)wid * 1024u;
    const int aoff = lds_byte(wr * 64 + fr, fq * 8), boff = lds_byte(wc * 32 + fr, fq * 8);
#define PG8_SA(b, h) (((b) * 2 + (h)) * HTB)
#define PG8_SB(b, h) ((4 + (b) * 2 + (h)) * HTB)
#define PG8_STAGE(bufoff, gbase, voff) do { _Pragma("unroll") for (int _i = 0; _i < 2; ++_i) \
        __builtin_amdgcn_global_load_lds((const unsigned*)((const char*)(gbase) + (voff)[_i]), (PG8_LAS unsigned*)(lds + (bufoff) + ldsw + _i * 8192), 16, 0, 0); } while (0)
#define PG8_LDA(dst, b, h) do { _Pragma("unroll") for (int m = 0; m < 4; ++m) _Pragma("unroll") for (int k = 0; k < 2; ++k) dst[m][k] = *(const PG8_LAS bf16x8*)(lds + PG8_SA(b, h) + aoff + m * 2048 + k * 1024); } while (0)
#define PG8_LDB(dst, b, h) do { _Pragma("unroll") for (int n = 0; n < 2; ++n) _Pragma("unroll") for (int k = 0; k < 2; ++k) dst[n][k] = *(const PG8_LAS bf16x8*)(lds + PG8_SB(b, h) + boff + n * 2048 + k * 1024); } while (0)
#define PG8_MMA(ai, bj, At, Bt) do { __builtin_amdgcn_s_setprio(1); _Pragma("unroll") for (int m = 0; m < 4; ++m) _Pragma("unroll") for (int n = 0; n < 2; ++n) _Pragma("unroll") for (int k = 0; k < 2; ++k) \
        acc[ai][bj][m][n] = __builtin_amdgcn_mfma_f32_16x16x32_bf16(Bt[n][k], At[m][k], acc[ai][bj][m][n], 0, 0, 0); __builtin_amdgcn_s_setprio(0); } while (0)
#define PG8_WAIT_V(n) asm volatile("s_waitcnt vmcnt(" #n ")" ::: "memory")
#define PG8_WAIT_L(n) asm volatile("s_waitcnt lgkmcnt(" #n ")" ::: "memory")
#define PG8_BAR __builtin_amdgcn_s_barrier()
#define PG8_SCHED __builtin_amdgcn_sched_barrier(0)
    Unit cur, nxt; int ui = 0;
    if (!S.next(0, cur)) return;
    f32x4 acc[2][2][4][2];
#pragma unroll
    for (int a = 0; a < 2; ++a)
#pragma unroll
        for (int b = 0; b < 2; ++b)
#pragma unroll
            for (int m = 0; m < 4; ++m)
#pragma unroll
                for (int n = 0; n < 2; ++n) acc[a][b][m][n] = (f32x4){0.f, 0.f, 0.f, 0.f};
    bf16x8 At[4][2], B0[2][2], B1[2][2];
    const char* cA = (const char*)g.A + (size_t)cur.pm * tstep; const char* cB = (const char*)g.Bt + (size_t)cur.pn * tstep;
    S.a_ready(cur);
    if constexpr (SP2) {
        PG8_STAGE(PG8_SB(0, 0), cB, voffB); PG8_STAGE(PG8_SB(0, 1), cB + hstep, voffB); PG8_STAGE(PG8_SA(0, 0), cA, voffA); PG8_STAGE(PG8_SA(0, 1), cA + hstep, voffA);
        if (wr == 1) PG8_BAR;
        PG8_WAIT_V(2); PG8_BAR;
        PG8_STAGE(PG8_SB(1, 0), cB + kstep, voffB); PG8_STAGE(PG8_SA(1, 0), cA + kstep, voffA); PG8_STAGE(PG8_SB(1, 1), cB + hstep + kstep, voffB);
        PG8_WAIT_V(6); PG8_BAR;
    } else {
        PG8_STAGE(PG8_SB(0, 0), cB, voffB); PG8_STAGE(PG8_SA(0, 0), cA, voffA); PG8_STAGE(PG8_SB(0, 1), cB + hstep, voffB); PG8_STAGE(PG8_SA(0, 1), cA + hstep, voffA);
        if (wr == 1) PG8_BAR;
        PG8_WAIT_V(4); PG8_BAR;
        PG8_STAGE(PG8_SB(1, 0), cB + kstep, voffB); PG8_STAGE(PG8_SA(1, 0), cA + kstep, voffA); PG8_STAGE(PG8_SB(1, 1), cB + hstep + kstep, voffB);
        PG8_WAIT_V(6); PG8_BAR;
    }
    for (;;) {
        const bool has_next = S.next(ui + 1, nxt);
        const char* nA = has_next ? (const char*)g.A + (size_t)nxt.pm * tstep : cA; const char* nB = has_next ? (const char*)g.Bt + (size_t)nxt.pn * tstep : cB;
        for (int t = 0; t < nt; t += 2) {
            const bool last = (t == nt - 2);
            const char* a1 = cA + (size_t)(t + 1) * kstep;
            const char* a2 = last ? nA : cA + (size_t)(t + 2) * kstep; const char* b2 = last ? nB : cB + (size_t)(t + 2) * kstep;
            const char* a3 = a2 + kstep; const char* b3 = b2 + kstep;
            if (last && has_next) S.a_ready(nxt);
            if constexpr (SP2) {
            PG8_LDB(B0, 0, 0); PG8_LDB(B1, 0, 1); PG8_SCHED; PG8_LDA(At, 0, 0); PG8_STAGE(PG8_SA(1, 1), a1 + hstep, voffA);
            PG8_WAIT_V(8); PG8_WAIT_L(0); PG8_BAR; PG8_MMA(0, 0, At, B0); PG8_MMA(0, 1, At, B1); PG8_BAR; PG8_SCHED;
            PG8_LDA(At, 0, 1); PG8_STAGE(PG8_SB(0, 0), b2, voffB); PG8_STAGE(PG8_SB(0, 1), b2 + hstep, voffB); PG8_STAGE(PG8_SA(0, 0), a2, voffA);
            PG8_WAIT_V(8); PG8_WAIT_L(0); PG8_BAR; PG8_MMA(1, 0, At, B0); PG8_MMA(1, 1, At, B1); PG8_BAR; PG8_SCHED;
            PG8_LDB(B0, 1, 0); PG8_LDB(B1, 1, 1); PG8_SCHED; PG8_LDA(At, 1, 0); PG8_STAGE(PG8_SA(0, 1), a2 + hstep, voffA);
            PG8_WAIT_V(8); PG8_WAIT_L(0); PG8_BAR; PG8_MMA(0, 0, At, B0); PG8_MMA(0, 1, At, B1); PG8_BAR; PG8_SCHED;
            PG8_LDA(At, 1, 1); PG8_STAGE(PG8_SB(1, 0), b3, voffB); PG8_STAGE(PG8_SB(1, 1), b3 + hstep, voffB); PG8_STAGE(PG8_SA(1, 0), a3, voffA);
            PG8_WAIT_V(8); PG8_WAIT_L(0); PG8_BAR; PG8_MMA(1, 0, At, B0); PG8_MMA(1, 1, At, B1); PG8_BAR; PG8_SCHED;
            } else {
            PG8_LDB(B0, 0, 0); PG8_SCHED; PG8_LDA(At, 0, 0); PG8_STAGE(PG8_SA(1, 1), a1 + hstep, voffA);
            PG8_WAIT_L(8); PG8_BAR; PG8_WAIT_L(0); PG8_MMA(0, 0, At, B0); PG8_BAR; PG8_SCHED;
            PG8_LDB(B1, 0, 1); PG8_STAGE(PG8_SB(0, 0), b2, voffB);
            PG8_BAR; PG8_WAIT_L(0); PG8_MMA(0, 1, At, B1); PG8_BAR;
            PG8_LDA(At, 0, 1); PG8_STAGE(PG8_SA(0, 0), a2, voffA);
            PG8_BAR; PG8_WAIT_L(0); PG8_MMA(1, 0, At, B0); PG8_BAR; PG8_SCHED;
            PG8_STAGE(PG8_SB(0, 1), b2 + hstep, voffB);
            PG8_WAIT_V(6); PG8_BAR; PG8_MMA(1, 1, At, B1); PG8_BAR;
            PG8_LDB(B0, 1, 0); PG8_SCHED; PG8_LDA(At, 1, 0); PG8_STAGE(PG8_SA(0, 1), a2 + hstep, voffA);
            PG8_WAIT_L(8); PG8_BAR; PG8_WAIT_L(0); PG8_MMA(0, 0, At, B0); PG8_BAR; PG8_SCHED;
            PG8_LDB(B1, 1, 1); PG8_STAGE(PG8_SB(1, 0), b3, voffB);
            PG8_BAR; PG8_WAIT_L(0); PG8_MMA(0, 1, At, B1); PG8_BAR;
            PG8_LDA(At, 1, 1); PG8_STAGE(PG8_SA(1, 0), a3, voffA);
            PG8_BAR; PG8_WAIT_L(0); PG8_MMA(1, 0, At, B0); PG8_BAR; PG8_SCHED;
            PG8_STAGE(PG8_SB(1, 1), b3 + hstep, voffB);
            PG8_WAIT_V(6); PG8_BAR; PG8_MMA(1, 1, At, B1); PG8_BAR;
            }
        }
        if constexpr (ALIGN_EPI) { if (wr == 0) PG8_BAR; }
        if constexpr (!Epi::AFTER_DRAIN) { E(acc, cur, wr, wc, fr, fq); S.done(cur); }
        if (!has_next) break;
#pragma unroll
        for (int a = 0; a < 2; ++a)
#pragma unroll
            for (int b = 0; b < 2; ++b)
#pragma unroll
                for (int m = 0; m < 4; ++m)
#pragma unroll
                    for (int n = 0; n < 2; ++n) acc[a][b][m][n] = (f32x4){0.f, 0.f, 0.f, 0.f};
        cur = nxt; cA = nA; cB = nB; ++ui;
        if constexpr (ALIGN_EPI) { if (wr == 1) PG8_BAR; }
    }
    PG8_WAIT_V(0);
    if constexpr (!ALIGN_EPI) { if (wr == 0) PG8_BAR; }
    PG8_BAR;
    if constexpr (Epi::AFTER_DRAIN) { E.fused(acc, cur, wr, wc, fr, fq, lds, wid, lane); S.done(cur); }
#undef PG8_SA
#undef PG8_SB
#undef PG8_STAGE
#undef PG8_LDA
#undef PG8_LDB
#undef PG8_MMA
#undef PG8_WAIT_V
#undef PG8_WAIT_L
#undef PG8_BAR
#undef PG8_SCHED
}
}
#define LAS __attribute__((address_space(3)))
#define DI __device__ __forceinline__
typedef unsigned short bf16_t;
typedef short bf16x8 __attribute__((ext_vector_type(8)));
typedef short s16x4 __attribute__((ext_vector_type(4)));
typedef float f32x16 __attribute__((ext_vector_type(16)));
typedef float f32x4 __attribute__((ext_vector_type(4)));
typedef unsigned u32x4 __attribute__((ext_vector_type(4)));
typedef unsigned u32x2 __attribute__((ext_vector_type(2)));
typedef float f32x2_t __attribute__((ext_vector_type(2)));
typedef __bf16 bf16x2_t __attribute__((ext_vector_type(2)));
DI unsigned cvtpk(float lo, float hi) { f32x2_t v = {lo, hi}; bf16x2_t b = __builtin_convertvector(v, bf16x2_t); return __builtin_bit_cast(unsigned, b); }
DI float bf_lo(unsigned u) { return __uint_as_float(u << 16); }
DI float bf_hi(unsigned u) { return __uint_as_float(u & 0xffff0000u); }
DI int crow(int i, int hh) { return (i & 3) + 8 * (i >> 2) + 4 * hh; }
DI float swap_max(float m) { auto rr = __builtin_amdgcn_permlane32_swap(__float_as_uint(m), __float_as_uint(m), false, false); return fmaxf(__uint_as_float(rr[0]), __uint_as_float(rr[1])); }
DI float swap_sum(float m) { auto rr = __builtin_amdgcn_permlane32_swap(__float_as_uint(m), __float_as_uint(m), false, false); return __uint_as_float(rr[0]) + __uint_as_float(rr[1]); }
DI s16x4 vtr(LAS const unsigned char* p) { return __builtin_bit_cast(s16x4, __builtin_amdgcn_ds_read_tr16_b64_v4i16((LAS s16x4*)p)); }
#define MFMA32(a, b, c) __builtin_amdgcn_mfma_f32_32x32x16_bf16((a), (b), (c), 0, 0, 0)
constexpr int KP = 144, TILE_B = 64 * KP, SLOT_B = 2 * TILE_B, NSLOT = 5;
constexpr int ATT_LDS = NSLOT * SLOT_B;
constexpr float SB_EXIT = 160.0f;
DI int slot_of(int T) { return T % NSLOT; }

template <int MODE>
DI void attn_unit(LAS unsigned char* lds, const bf16_t* __restrict__ P, bf16_t* __restrict__ Y, const float* __restrict__ sinks, int b, int h, int qb) {
    const int tid = threadIdx.x, lane = tid & 63, r = lane & 31, hh = lane >> 5;
    const int wid = __builtin_amdgcn_readfirstlane(tid >> 6);
    const size_t rowbase = (size_t)b * SEQ;
    const int q0w = qb * 256 + wid * 32;
    const int qcol = MODE == 0 ? h * 64 : 2048 + h * 64;
    const int kcol = MODE == 0 ? 512 + h * 64 : 2560 + (h >> 2) * 64;
    const int vcol = MODE == 0 ? 1024 + h * 64 : 2688 + (h >> 2) * 64;
    const int gcol = MODE == 0 ? 1536 + h * 64 : 2816 + h * 64;
    const int ycol = MODE == 0 ? h * 64 : 512 + h * 64;
    const int skey = tid >> 3, sch = tid & 7;
    const bf16_t* kg = P + (rowbase + skey) * NIN + kcol + sch * 8;
    const bf16_t* vg = P + (rowbase + skey) * NIN + vcol + sch * 8;
    const int soff = skey * KP + sch * 16;
    { u32x4 kr[4], vr[4];
#pragma unroll
      for (int i = 0; i < 4; ++i) { kr[i] = *(const u32x4*)(kg + (size_t)(4 * qb + i) * 64 * NIN); vr[i] = *(const u32x4*)(vg + (size_t)(4 * qb + i) * 64 * NIN); }
#pragma unroll
      for (int i = 0; i < 4; ++i) { LAS unsigned char* sb = lds + slot_of(4 * qb + i) * SLOT_B; *(LAS u32x4*)(sb + soff) = kr[i]; *(LAS u32x4*)(sb + TILE_B + soff) = vr[i]; } }
    int tn = 4 * qb - 1;
    u32x4 kreg = {0u, 0u, 0u, 0u}, vreg = {0u, 0u, 0u, 0u};
    if (tn >= 0) { kreg = *(const u32x4*)(kg + (size_t)tn * 64 * NIN); vreg = *(const u32x4*)(vg + (size_t)tn * 64 * NIN); }
    bf16x8 qf[4];
    { const bf16_t* qp = P + (rowbase + q0w + r) * NIN + qcol + 8 * hh;
#pragma unroll
      for (int s = 0; s < 4; ++s) qf[s] = *(const bf16x8*)(qp + 16 * s); }
    bf16x8 tm[2], ones;
#pragma unroll
    for (int s = 0; s < 2; ++s)
#pragma unroll
        for (int j = 0; j < 8; ++j) tm[s][j] = ((16 * s + 8 * (j >> 2) + 4 * hh + (j & 3)) > r) ? (short)0x3F80 : (short)0;
#pragma unroll
    for (int j = 0; j < 8; ++j) ones[j] = (short)0x3F80;
    f32x16 o0, o1, carry;
#pragma unroll
    for (int i = 0; i < 16; ++i) { o0[i] = 0.f; o1[i] = 0.f; carry[i] = 0.f; }
    float mrun = 0.f, lsum = 0.f, slope2 = 0.f;
    if (MODE == 1) { mrun = sinks[h] * LOG2E; lsum = hh == 0 ? 1.f : 0.f; slope2 = __builtin_amdgcn_exp2f(-(float)(h + 1)) * LOG2E; }
    const int vtoff = (4 * hh + ((lane & 15) >> 2)) * KP + ((lane >> 4) & 1) * 32 + (lane & 3) * 8;
    const int Dw = 4 * qb + (wid >> 1);
    bool wdone = false;
    __syncthreads();
    for (int j = 0;; ++j) {
        const int T = Dw - j;
        if (T >= 0 && !wdone) {
            LAS unsigned char* kb = lds + slot_of(T) * SLOT_B; LAS unsigned char* vb = kb + TILE_B;
#pragma unroll
            for (int c = 1; c >= 0; --c) {
                const int ks = 64 * T + 32 * c;
                const bool active = MODE == 0 ? (ks <= q0w && !wdone) : (ks <= q0w && ks >= q0w - 128);
                if (active) {
                    f32x16 z;
#pragma unroll
                    for (int i = 0; i < 16; ++i) z[i] = 0.f;
#pragma unroll
                    for (int s = 0; s < 4; ++s) { const bf16x8 kf = *(LAS const bf16x8*)(kb + (32 * c + r) * KP + (16 * s + 8 * hh) * 2); z = MFMA32(kf, qf[s], z); }
                    u32x4 wk0, wk1;
                    if (MODE == 0) {
                        const bool diag = (ks == q0w);
                        f32x16 sp;
#pragma unroll
                        for (int i = 0; i < 16; ++i) {
                            const float zz = z[i];
                            const float uu = __builtin_amdgcn_exp2f(-fabsf(zz));
                            float s_ = fmaxf(zz, 0.f) + __builtin_amdgcn_logf(1.0f + uu);
                            if (diag && !(crow(i, hh) < r)) s_ = 0.f;
                            sp[i] = s_;
                        }
                        u32x4 sk0, sk1;
                        sk0.x = cvtpk(sp[0], sp[1]); sk0.y = cvtpk(sp[2], sp[3]); sk0.z = cvtpk(sp[4], sp[5]); sk0.w = cvtpk(sp[6], sp[7]);
                        sk1.x = cvtpk(sp[8], sp[9]); sk1.y = cvtpk(sp[10], sp[11]); sk1.z = cvtpk(sp[12], sp[13]); sk1.w = cvtpk(sp[14], sp[15]);
                        const bf16x8 s0 = __builtin_bit_cast(bf16x8, sk0), s1 = __builtin_bit_cast(bf16x8, sk1);
                        f32x16 yc = MFMA32(tm[0], s0, carry); yc = MFMA32(tm[1], s1, yc);
                        carry = MFMA32(ones, s0, carry); carry = MFMA32(ones, s1, carry);
                        f32x16 w;
#pragma unroll
                        for (int i = 0; i < 16; ++i) {
                            float e = __builtin_amdgcn_exp2f(z[i] - sp[i] - yc[i]);
                            if (diag && !(crow(i, hh) < r)) e = 0.f;
                            w[i] = e;
                        }
                        wk0.x = cvtpk(w[0], w[1]); wk0.y = cvtpk(w[2], w[3]); wk0.z = cvtpk(w[4], w[5]); wk0.w = cvtpk(w[6], w[7]);
                        wk1.x = cvtpk(w[8], w[9]); wk1.y = cvtpk(w[10], w[11]); wk1.z = cvtpk(w[12], w[13]); wk1.w = cvtpk(w[14], w[15]);
                        wdone = __all(carry[0] >= SB_EXIT) != 0;
                    } else {
                        const float relb = (float)(q0w - ks + r - 4 * hh);
                        float mx = -1e30f;
#pragma unroll
                        for (int i = 0; i < 16; ++i) {
                            const float rel = relb - (float)((i & 3) + 8 * (i >> 2));
                            const bool valid = rel >= 0.f && rel < 128.f;
                            const float l = valid ? z[i] - slope2 * rel : -1e30f;
                            z[i] = l; mx = fmaxf(mx, l);
                        }
                        mx = swap_max(mx);
                        const float mnew = fmaxf(mrun, mx);
                        const float alpha = __builtin_amdgcn_exp2f(mrun - mnew);
                        mrun = mnew; lsum *= alpha;
#pragma unroll
                        for (int i = 0; i < 16; ++i) { o0[i] *= alpha; o1[i] *= alpha; }
                        float ps = 0.f;
#pragma unroll
                        for (int i = 0; i < 16; ++i) { z[i] = __builtin_amdgcn_exp2f(z[i] - mnew); ps += z[i]; }
                        lsum += ps;
                        wk0.x = cvtpk(z[0], z[1]); wk0.y = cvtpk(z[2], z[3]); wk0.z = cvtpk(z[4], z[5]); wk0.w = cvtpk(z[6], z[7]);
                        wk1.x = cvtpk(z[8], z[9]); wk1.y = cvtpk(z[10], z[11]); wk1.z = cvtpk(z[12], z[13]); wk1.w = cvtpk(z[14], z[15]);
                    }
                    const bf16x8 w0 = __builtin_bit_cast(bf16x8, wk0), w1 = __builtin_bit_cast(bf16x8, wk1);
                    LAS const unsigned char* vp = vb + (32 * c) * KP + vtoff;
#pragma unroll
                    for (int s = 0; s < 2; ++s) {
                        const s16x4 a0 = vtr(vp + (16 * s) * KP), a1 = vtr(vp + (16 * s + 8) * KP);
                        const s16x4 b0 = vtr(vp + (16 * s) * KP + 64), b1 = vtr(vp + (16 * s + 8) * KP + 64);
                        const bf16x8 va = (bf16x8){a0[0], a0[1], a0[2], a0[3], a1[0], a1[1], a1[2], a1[3]};
                        const bf16x8 vbq = (bf16x8){b0[0], b0[1], b0[2], b0[3], b1[0], b1[1], b1[2], b1[3]};
                        o0 = MFMA32(va, s == 0 ? w0 : w1, o0);
                        o1 = MFMA32(vbq, s == 0 ? w0 : w1, o1);
                    }
                }
            }
        }
        if (T <= 0) wdone = true;
        if (MODE == 1 && j >= 2) wdone = true;
        if (tn >= 0) { LAS unsigned char* sb = lds + slot_of(tn) * SLOT_B; *(LAS u32x4*)(sb + soff) = kreg; *(LAS u32x4*)(sb + TILE_B + soff) = vreg; }
        const int cont = __syncthreads_or(wdone ? 0 : 1);
        if (!cont) break;
        tn -= 1;
        if (tn >= 0) { kreg = *(const u32x4*)(kg + (size_t)tn * 64 * NIN); vreg = *(const u32x4*)(vg + (size_t)tn * 64 * NIN); }
    }
    if (MODE == 1) { const float inv = 1.0f / swap_sum(lsum);
#pragma unroll
        for (int i = 0; i < 16; ++i) { o0[i] *= inv; o1[i] *= inv; } }
    { bf16_t* yrow = Y + (rowbase + q0w + r) * DM + ycol; const bf16_t* grow = P + (rowbase + q0w + r) * NIN + gcol;
#pragma unroll
      for (int db = 0; db < 2; ++db)
#pragma unroll
        for (int g4 = 0; g4 < 4; ++g4) {
            const int d0 = 32 * db + 8 * g4 + 4 * hh;
            const u32x2 gg = *(const u32x2*)(grow + d0);
            const float v0 = (db == 0 ? o0 : o1)[4 * g4 + 0] * bf_lo(gg.x), v1 = (db == 0 ? o0 : o1)[4 * g4 + 1] * bf_hi(gg.x);
            const float v2 = (db == 0 ? o0 : o1)[4 * g4 + 2] * bf_lo(gg.y), v3 = (db == 0 ? o0 : o1)[4 * g4 + 3] * bf_hi(gg.y);
            u32x2 ov; ov.x = cvtpk(v0, v1); ov.y = cvtpk(v2, v3);
            *(u32x2*)(yrow + d0) = ov;
        } }
}

constexpr size_t MiB = 1u << 20;
constexpr size_t WS_PART = 1 * MiB;
constexpr size_t WS_GATE = 1 * MiB + 512 * 1024;
constexpr size_t WS_SSQ  = 1 * MiB + 768 * 1024;
constexpr size_t WS_WIN  = 2 * MiB;
constexpr size_t WS_WOUT = 10 * MiB;
constexpr size_t WS_H    = 16 * MiB;
constexpr size_t WS_P    = 80 * MiB;
constexpr size_t WS_END  = WS_P + (size_t)MTOK * NIN * 2;
constexpr int LDS_BYTES = 147456;
constexpr int NWAVES = 8;

DI float wave_sum(float v) {
#pragma unroll
    for (int o = 1; o < 64; o <<= 1) v += __shfl_xor(v, o);
    return v;
}
DI unsigned f2bf(float f) { unsigned u = __builtin_bit_cast(unsigned, f); return (u + 0x7fffu + ((u >> 16) & 1u)) >> 16; }
DI unsigned pk2(float lo, float hi) { return f2bf(lo) | (f2bf(hi) << 16); }
DI void transpose_item(const float* __restrict__ W, int K, int N, bf16_t* __restrict__ WT, LAS float* scr, int item, int lane) {
    const int nblk = N / 32, kb = item / nblk, nb = item % nblk, k0 = 64 * kb, n0 = 32 * nb;
#pragma unroll 8
    for (int i = 0; i < 32; ++i) { const int kk = 2 * i + (lane >> 5); scr[kk * 33 + (lane & 31)] = W[(size_t)(k0 + kk) * N + n0 + (lane & 31)]; }
    asm volatile("s_waitcnt lgkmcnt(0)" ::: "memory");
    const int c = lane & 7;
#pragma unroll
    for (int j = 0; j < 4; ++j) { const int n = (lane >> 3) + 8 * j; const LAS float* s = scr + (8 * c) * 33 + n;
        u32x4 o; o.x = pk2(s[0 * 33], s[1 * 33]); o.y = pk2(s[2 * 33], s[3 * 33]); o.z = pk2(s[4 * 33], s[5 * 33]); o.w = pk2(s[6 * 33], s[7 * 33]);
        *(u32x4*)(WT + (size_t)(n0 + n) * K + k0 + 8 * c) = o; }
    asm volatile("s_waitcnt lgkmcnt(0)" ::: "memory");
}

#ifndef PROBE_REP
#define PROBE_REP -1
#endif
struct Args { const float* in[9]; float* out; unsigned char* ws; int ph_lo, ph_hi; };
constexpr int N_PHASES = 6;

__global__ void __launch_bounds__(NWAVES * 64, 2) hymba_fwd(Args args) {
    extern __shared__ __attribute__((aligned(16))) unsigned char lds_raw[];
    LAS unsigned char* lds = (LAS unsigned char*)lds_raw;
    const int tid = threadIdx.x, lane = tid & 63, wave = __builtin_amdgcn_readfirstlane(tid >> 6);
    const int G = gridDim.x; const int bx = blockIdx.x;
    const int vcu = (G % 8 == 0) ? (bx % 8) * (G / 8) + bx / 8 : bx;
    const float* x = args.in[0]; const float* cvec = args.in[1]; const float* w_ada = args.in[2]; const float* b_ada = args.in[3]; const float* norm_g = args.in[4];
    const float* w_in = args.in[5]; const float* sinks = args.in[6]; const float* w_out = args.in[7]; const float* final_g = args.in[8];
    float* out = args.out; unsigned char* ws = args.ws;
    float* part = (float*)(ws + WS_PART); float* gate = (float*)(ws + WS_GATE); float* ssq = (float*)(ws + WS_SSQ);
    bf16_t* win_t = (bf16_t*)(ws + WS_WIN); bf16_t* wout_t = (bf16_t*)(ws + WS_WOUT); bf16_t* hbuf = (bf16_t*)(ws + WS_H); bf16_t* pbuf = (bf16_t*)(ws + WS_P);
    const int lo = args.ph_lo, hi = args.ph_hi;
#define IN(k) (lo <= (k) && (k) < hi)
#define SEAM(k) do { if (IN(k) && IN((k) + 1)) { cg::this_grid().sync(); } } while (0)
    const int gw = vcu * NWAVES + wave, NGW = G * NWAVES;

    if (IN(0)) for (int rep_ = 0; rep_ < (PROBE_REP == 0 ? 2 : 1); ++rep_) {
        for (int i = bx * 512 + tid; i < MTOK; i += G * 512) ssq[i] = 0.f;
        for (int t = bx; t < 192; t += G) {
            const int cc = t % 48, kq = t / 48;
            LAS float* sc = (LAS float*)lds; LAS float* red = (LAS float*)(lds + 8192);
            for (int i = tid; i < 2048; i += 512) { const int b = i >> 8, kk = i & 255; const float cv = cvec[b * DM + kq * 256 + kk]; sc[i] = cv / (1.0f + __expf(-cv)); }
            __syncthreads();
            const int col = cc * 64 + lane, k0 = wave * 32;
            float a0 = 0.f, a1 = 0.f, a2 = 0.f, a3 = 0.f, a4 = 0.f, a5 = 0.f, a6 = 0.f, a7 = 0.f;
#pragma unroll 8
            for (int i = 0; i < 32; ++i) {
                const float w = w_ada[(size_t)(kq * 256 + k0 + i) * NADA + col];
                a0 += w * sc[0 * 256 + k0 + i]; a1 += w * sc[1 * 256 + k0 + i]; a2 += w * sc[2 * 256 + k0 + i]; a3 += w * sc[3 * 256 + k0 + i];
                a4 += w * sc[4 * 256 + k0 + i]; a5 += w * sc[5 * 256 + k0 + i]; a6 += w * sc[6 * 256 + k0 + i]; a7 += w * sc[7 * 256 + k0 + i];
            }
            red[(wave * 8 + 0) * 64 + lane] = a0; red[(wave * 8 + 1) * 64 + lane] = a1; red[(wave * 8 + 2) * 64 + lane] = a2; red[(wave * 8 + 3) * 64 + lane] = a3;
            red[(wave * 8 + 4) * 64 + lane] = a4; red[(wave * 8 + 5) * 64 + lane] = a5; red[(wave * 8 + 6) * 64 + lane] = a6; red[(wave * 8 + 7) * 64 + lane] = a7;
            __syncthreads();
            { const int b = tid >> 6; float s = 0.f;
#pragma unroll
              for (int w = 0; w < 8; ++w) s += red[(w * 8 + b) * 64 + lane];
              part[(size_t)(kq * 8 + b) * NADA + cc * 64 + lane] = s; }
            __syncthreads();
        }
        LAS float* scr = (LAS float*)(lds + wave * 16384);
        constexpr int I_IN = (DM / 64) * (NIN / 32), I_OUT = (DM / 64) * (DM / 32);
        for (int it = gw; it < I_IN + I_OUT; it += NGW) {
            if (it < I_IN) transpose_item(w_in, DM, NIN, win_t, scr, it, lane);
            else transpose_item(w_out, DM, DM, wout_t, scr, it - I_IN, lane);
        }
    }
    SEAM(0);
    if (IN(1)) for (int rep_ = 0; rep_ < (PROBE_REP == 1 ? 2 : 1); ++rep_) {
        for (int i = bx * 512 + tid; i < BATCH * DM; i += G * 512) { const int b = i >> 10, j = 2048 + (i & 1023);
            gate[i] = b_ada[j] + ((part[(size_t)(0 * 8 + b) * NADA + j] + part[(size_t)(1 * 8 + b) * NADA + j]) + (part[(size_t)(2 * 8 + b) * NADA + j] + part[(size_t)(3 * 8 + b) * NADA + j])); }
        for (int rb = gw; rb < MTOK / 16; rb += NGW) {
            const int row0 = rb * 16, b = row0 / SEQ;
            f32x4 av[4], sh[4];
#pragma unroll
            for (int j = 0; j < 4; ++j) {
                const int col = 4 * lane + 256 * j;
                f32x4 shv = *(const f32x4*)(b_ada + col), scv = *(const f32x4*)(b_ada + 1024 + col);
#pragma unroll
                for (int kq = 0; kq < 4; ++kq) { shv += *(const f32x4*)(part + (size_t)(kq * 8 + b) * NADA + col); scv += *(const f32x4*)(part + (size_t)(kq * 8 + b) * NADA + 1024 + col); }
                const f32x4 gv = *(const f32x4*)(norm_g + col);
                av[j] = gv * (scv + 1.0f); sh[j] = shv;
            }
            for (int rr = 0; rr < 16; ++rr) {
                const float* xr = x + (size_t)(row0 + rr) * DM + 4 * lane;
                f32x4 v[4]; float s = 0.f;
#pragma unroll
                for (int j = 0; j < 4; ++j) { v[j] = *(const f32x4*)(xr + 256 * j); s += (v[j].x * v[j].x + v[j].y * v[j].y) + (v[j].z * v[j].z + v[j].w * v[j].w); }
                const float inv = 1.0f / sqrtf(wave_sum(s) * (1.0f / DM) + RMS_EPS);
                bf16_t* hr = hbuf + (size_t)(row0 + rr) * DM + 4 * lane;
#pragma unroll
                for (int j = 0; j < 4; ++j) { const f32x4 o = v[j] * inv * av[j] + sh[j]; u32x2 w; w.x = cvtpk(o.x, o.y); w.y = cvtpk(o.z, o.w); *(u32x2*)(hr + 256 * j) = w; }
            }
        }
    }
    SEAM(1);
    if (IN(2)) for (int rep_ = 0; rep_ < (PROBE_REP == 2 ? 2 : 1); ++rep_) {
        pg8::Gemm g{hbuf, win_t, MTOK, NIN, DM}; pg8::StaticOrder S; S.init(MTOK, NIN, G, bx);
        pg8::EpiProj E{pbuf};
        pg8::gemm_phase<pg8::EpiProj, pg8::StaticOrder, true, true>(lds, g, S, E);
    }
    SEAM(2);
    if (IN(3)) for (int rep_ = 0; rep_ < (PROBE_REP == 3 ? 2 : 1); ++rep_) {
        bf16_t* ymix = hbuf;
        for (int v = vcu; v < 256; v += G) {
            const int bh = v >> 2, s = v & 3;
#pragma unroll 1
            for (int i = 0; i < 4; ++i) attn_unit<0>(lds, pbuf, ymix, sinks, bh >> 3, bh & 7, 4 * s + 3 - i);
#pragma unroll 1
            for (int i = 0; i < 4; ++i) attn_unit<1>(lds, pbuf, ymix, sinks, bh >> 3, bh & 7, 4 * s + i);
        }
    }
    SEAM(3);
    if (IN(4)) {
        pg8::Gemm g{hbuf, wout_t, MTOK, DM, DM}; pg8::StaticOrder S; S.init(MTOK, DM, G, bx);
        pg8::EpiOut E{x, gate, out, ssq};
        pg8::gemm_phase<pg8::EpiOut, pg8::StaticOrder, true, true>(lds, g, S, E);
    }
    SEAM(4);
    if (IN(5)) {
        f32x4 fg[4];
#pragma unroll
        for (int j = 0; j < 4; ++j) fg[j] = *(const f32x4*)(final_g + 4 * lane + 256 * j);
        for (int row = gw; row < MTOK; row += NGW) {
            const float inv = 1.0f / sqrtf(__hip_atomic_load(ssq + row, __ATOMIC_RELAXED, __HIP_MEMORY_SCOPE_AGENT) * (1.0f / DM) + RMS_EPS);
            float* orow = out + (size_t)row * DM + 4 * lane;
#pragma unroll
            for (int j = 0; j < 4; ++j) { const f32x4 v = *(const f32x4*)(orow + 256 * j); *(f32x4*)(orow + 256 * j) = v * inv * fg[j]; }
        }
    }
#undef IN
#undef SEAM
}

extern "C" void kernel_launch(void* const* d_in, const int* in_sizes, int n_in, void* d_out, int out_size, void* d_ws, size_t ws_size, hipStream_t stream) {
    static int grid = 0;
    if (grid == 0) {
        if (n_in != 9 || out_size != MTOK * DM || ws_size < WS_END) { fprintf(stderr, "kernel_launch: unexpected shapes (n_in %d out %d ws %zu)\n", n_in, out_size, ws_size); grid = -1; return; }
        int dev = 0, cus = 0, per_cu = 0;
        hipGetDevice(&dev); hipDeviceGetAttribute(&cus, hipDeviceAttributeMultiprocessorCount, dev);
        if (hipFuncSetAttribute((const void*)hymba_fwd, hipFuncAttributeMaxDynamicSharedMemorySize, LDS_BYTES) != hipSuccess) { fprintf(stderr, "kernel_launch: hipFuncSetAttribute failed\n"); grid = -1; return; }
        if (hipOccupancyMaxActiveBlocksPerMultiprocessor(&per_cu, (const void*)hymba_fwd, NWAVES * 64, LDS_BYTES) != hipSuccess || per_cu < 1) { fprintf(stderr, "kernel_launch: occupancy query says %d\n", per_cu); per_cu = 1; }
        (void)hipGetLastError();
        grid = cus * 1;
    }
    if (grid < 0) return;
    Args a{};
    for (int i = 0; i < 9; ++i) a.in[i] = (const float*)d_in[i];
    a.out = (float*)d_out; a.ws = (unsigned char*)d_ws;
#if MK_N_LAUNCHES == 1
    a.ph_lo = 0; a.ph_hi = N_PHASES;
    void* kargs[] = {&a};
    hipError_t e = hipLaunchCooperativeKernel((const void*)hymba_fwd, dim3(grid), dim3(NWAVES * 64), kargs, LDS_BYTES, stream);
    if (e != hipSuccess) fprintf(stderr, "cooperative launch failed: %s (grid %d)\n", hipGetErrorString(e), grid);
#else
    for (int p = 0; p < N_PHASES; ++p) { a.ph_lo = p; a.ph_hi = p + 1; hipLaunchKernelGGL(hymba_fwd, dim3(grid), dim3(NWAVES * 64), LDS_BYTES, stream, a); }
#endif
}
```
